# Optimizing an MI355X kernel written in HIP

```python
import math
import jax, jax.numpy as jnp
from jax import lax
import numpy as np

D_MODEL = 1024
BATCH = 2
SEQ = 8192
DEPTH = 1

GDN_HEADS = 4
GDN_DK = 128
GDN_DV = 128
GDN_QK = GDN_HEADS * GDN_DK
GDN_WIDTH = GDN_HEADS * GDN_DV
GDN_CHUNK = 64
CONV_K = 4
DIFF_HEADS = 4
DIFF_DH = 64
DIFF_DV = 2 * DIFF_DH
DIFF_QK = DIFF_HEADS * 2 * DIFF_DH
DIFF_WIDTH = DIFF_HEADS * DIFF_DV
Q_BLOCK = 128
SPLITS = (GDN_QK, GDN_QK, GDN_WIDTH, GDN_HEADS, GDN_HEADS, GDN_WIDTH,
          DIFF_QK, DIFF_QK, DIFF_WIDTH, DIFF_WIDTH, D_MODEL, D_MODEL)
IN_WIDTH = sum(SPLITS)
NORM_EPS = 1e-6
SUBLN_EPS = 1e-5
LN_EPS = 1e-5
DEEPNORM_ALPHA = (2.0 * DEPTH) ** 0.25
DEEPNORM_BETA = (8.0 * DEPTH) ** -0.25

kernel_name = "hybrid_gdn_diffattn_deepnorm"


def _split_points():
    pts, acc = [], 0
    for s in SPLITS[:-1]:
        acc += s
        pts.append(acc)
    return pts


def _l2norm(t):
    return t * lax.rsqrt(jnp.sum(t * t, axis=-1, keepdims=True) + NORM_EPS)


def _rms_norm(t, w, eps):
    t = t.astype(jnp.float32)
    return t * lax.rsqrt(jnp.mean(t * t, axis=-1, keepdims=True) + eps) * w.astype(jnp.float32)


def _layer_norm(t, g, b):
    t32 = t.astype(jnp.float32)
    mu = jnp.mean(t32, axis=-1, keepdims=True)
    var = jnp.mean(jnp.square(t32 - mu), axis=-1, keepdims=True)
    out = (t32 - mu) * lax.rsqrt(var + LN_EPS) * g.astype(jnp.float32) + b.astype(jnp.float32)
    return out.astype(t.dtype)


def _causal_depthwise_conv(t, w):
    c = t.shape[-1]
    return lax.conv_general_dilated(
        t, w[:, None, :].astype(t.dtype), window_strides=(1,),
        padding=[(CONV_K - 1, 0)], dimension_numbers=("NWC", "WIO", "NWC"),
        feature_group_count=c)


def _alibi_slopes(n):
    return 2.0 ** (-8.0 * jnp.arange(1, n + 1, dtype=jnp.float32) / n)


def _gated_delta_rule(q, k, v, g, beta):
    B, S, H, DK = q.shape
    DV = v.shape[-1]
    C = GDN_CHUNK
    N = S // C
    q = q * (DK ** -0.5)

    def to_chunks(t):
        return jnp.moveaxis(t, 1, 2).reshape((B, H, N, C) + t.shape[3:])

    qc, kc, vc = to_chunks(q), to_chunks(k), to_chunks(v)
    gc = jnp.cumsum(to_chunks(g), axis=-1)
    bc = to_chunks(beta)
    causal = jnp.tril(jnp.ones((C, C), dtype=bool))
    strict = jnp.tril(jnp.ones((C, C), dtype=bool), -1)
    gdiff = gc[..., :, None] - gc[..., None, :]
    decay = jnp.where(causal, jnp.exp(jnp.where(causal, gdiff, 0.0)), 0.0)
    kb = kc * bc[..., None]
    lmat = jnp.where(strict, jnp.einsum("bhncd,bhnsd->bhncs", kb, kc) * decay, 0.0)
    tmat = lmat + jnp.eye(C, dtype=lmat.dtype)
    rhs = jnp.concatenate([vc * bc[..., None], kb * jnp.exp(gc)[..., None]], axis=-1)
    sol = lax.linalg.triangular_solve(tmat, rhs, left_side=True, lower=True,
                                      unit_diagonal=True)
    u, w = sol[..., :DV], sol[..., DV:]
    qk_intra = jnp.where(causal, jnp.einsum("bhncd,bhnsd->bhncs", qc, kc) * decay, 0.0)

    def step(state, inp):
        q_i, k_i, u_i, w_i, g_i, a_i = inp
        v_new = u_i - jnp.einsum("bhck,bhkv->bhcv", w_i, state)
        o = (jnp.einsum("bhck,bhkv->bhcv", q_i * jnp.exp(g_i)[..., None], state)
             + jnp.einsum("bhcs,bhsv->bhcv", a_i, v_new))
        g_last = g_i[..., -1]
        state = (state * jnp.exp(g_last)[..., None, None]
                 + jnp.einsum("bhck,bhcv->bhkv",
                              k_i * jnp.exp(g_last[..., None] - g_i)[..., None], v_new))
        return state, o

    xs = tuple(jnp.moveaxis(t, 2, 0) for t in (qc, kc, u, w, gc, qk_intra))
    state0 = jnp.zeros((B, H, DK, DV), dtype=jnp.float32)
    _, o = lax.scan(step, state0, xs)
    o = jnp.moveaxis(o, 0, 2).reshape(B, H, S, DV)
    return jnp.moveaxis(o, 1, 2)


def _diff_attention(q, k, v, lam, slopes):
    S = q.shape[1]
    q = q.astype(jnp.float32) * (DIFF_DH ** -0.5)
    k = k.astype(jnp.float32)
    v = v.astype(jnp.float32)
    outs = []
    for blk in range(S // Q_BLOCK):
        start = blk * Q_BLOCK
        end = start + Q_BLOCK
        qb, kb, vb = q[:, start:end], k[:, :end], v[:, :end]
        s = jnp.einsum("bqhmd,bkhmd->bhmqk", qb, kb)
        dist = (jnp.arange(start, end)[:, None] - jnp.arange(end)[None, :]).astype(jnp.float32)
        bias = jnp.where(dist[None] >= 0, -slopes[:, None, None] * dist[None], -jnp.inf)
        p = jax.nn.softmax(s + bias[None, :, None], axis=-1)
        attn = p[:, :, 0] - lam * p[:, :, 1]
        outs.append(jnp.einsum("bhqk,bkhv->bqhv", attn, vb))
    return jnp.concatenate(outs, axis=1)


def setup_inputs(seed: int = 0) -> dict:
    key = jax.random.key(seed)
    ks = jax.random.split(key, 17)
    f32 = jnp.float32
    col_scale = jnp.concatenate([
        jnp.full((s,), DEEPNORM_BETA if i in (2, 8) else 1.0, dtype=f32)
        for i, s in enumerate(SPLITS)])
    x = jax.random.normal(ks[0], (BATCH, SEQ, D_MODEL), f32)
    w_in = jax.random.normal(ks[1], (DEPTH, D_MODEL, IN_WIDTH), f32) * (D_MODEL ** -0.5) * col_scale
    conv_w = jax.random.normal(ks[2], (DEPTH, CONV_K, 2 * GDN_QK + GDN_WIDTH), f32) * (CONV_K ** -0.5)
    a_log = jnp.log(jax.random.uniform(ks[3], (DEPTH, GDN_HEADS), f32, 1.0, 16.0))
    dt = jnp.exp(jax.random.uniform(ks[4], (DEPTH, GDN_HEADS), f32, math.log(1e-3), math.log(1e-1)))
    dt_bias = dt + jnp.log(-jnp.expm1(-dt))
    gdn_norm_w = 1.0 + 0.02 * jax.random.normal(ks[5], (DEPTH, GDN_DV), f32)
    w_up_a = jax.random.normal(ks[6], (DEPTH, GDN_WIDTH, D_MODEL), f32) * (GDN_WIDTH ** -0.5) * DEEPNORM_BETA
    lambda_q1 = 0.1 * jax.random.normal(ks[7], (DEPTH, DIFF_DH), f32)
    lambda_k1 = 0.1 * jax.random.normal(ks[8], (DEPTH, DIFF_DH), f32)
    lambda_q2 = 0.1 * jax.random.normal(ks[9], (DEPTH, DIFF_DH), f32)
    lambda_k2 = 0.1 * jax.random.normal(ks[10], (DEPTH, DIFF_DH), f32)
    diff_norm_w = 1.0 + 0.02 * jax.random.normal(ks[11], (DEPTH, DIFF_DV), f32)
    w_up_b = jax.random.normal(ks[12], (DEPTH, DIFF_WIDTH, D_MODEL), f32) * (DIFF_WIDTH ** -0.5) * DEEPNORM_BETA
    w_out = jax.random.normal(ks[13], (DEPTH, D_MODEL, D_MODEL), f32) * (D_MODEL ** -0.5) * DEEPNORM_BETA
    ln_g = 1.0 + 0.02 * jax.random.normal(ks[14], (DEPTH, D_MODEL), f32)
    ln_b = 0.02 * jax.random.normal(ks[15], (DEPTH, D_MODEL), f32)
    return {"x": x, "w_in": w_in, "conv_w": conv_w, "a_log": a_log, "dt_bias": dt_bias,
            "gdn_norm_w": gdn_norm_w, "w_up_a": w_up_a, "lambda_q1": lambda_q1,
            "lambda_k1": lambda_k1, "lambda_q2": lambda_q2, "lambda_k2": lambda_k2,
            "diff_norm_w": diff_norm_w, "w_up_b": w_up_b, "w_out": w_out,
            "ln_g": ln_g, "ln_b": ln_b}


def reference(x, w_in, conv_w, a_log, dt_bias, gdn_norm_w, w_up_a, lambda_q1, lambda_k1,
              lambda_q2, lambda_k2, diff_norm_w, w_up_b, w_out, ln_g, ln_b):
    B, S, _ = x.shape
    f32 = jnp.float32
    slopes = _alibi_slopes(DIFF_HEADS)
    pts = _split_points()
    for layer in range(DEPTH):
        h = x @ w_in[layer]
        gq, gk, gv, ga, gb, gz, dq, dk, dv, dz, ma, mb = jnp.split(h, pts, axis=-1)

        qkv = jax.nn.silu(_causal_depthwise_conv(jnp.concatenate([gq, gk, gv], axis=-1), conv_w[layer]))
        cq, ck, cv = jnp.split(qkv.astype(f32), [GDN_QK, 2 * GDN_QK], axis=-1)
        q_a = _l2norm(cq.reshape(B, S, GDN_HEADS, GDN_DK))
        k_a = _l2norm(ck.reshape(B, S, GDN_HEADS, GDN_DK))
        v_a = cv.reshape(B, S, GDN_HEADS, GDN_DV)
        beta = jax.nn.sigmoid(gb.astype(f32))
        g = -jnp.exp(a_log[layer].astype(f32)) * jax.nn.softplus(ga.astype(f32) + dt_bias[layer].astype(f32))
        o_a = _gated_delta_rule(q_a, k_a, v_a, g, beta)
        o_a = _rms_norm(o_a, gdn_norm_w[layer], NORM_EPS) * jax.nn.silu(
            gz.astype(f32).reshape(B, S, GDN_HEADS, GDN_DV))
        y_a = o_a.reshape(B, S, GDN_WIDTH).astype(x.dtype) @ w_up_a[layer]

        lam_init = 0.8 - 0.6 * math.exp(-0.3 * layer)
        lam = (jnp.exp(jnp.sum(lambda_q1[layer].astype(f32) * lambda_k1[layer].astype(f32)))
               - jnp.exp(jnp.sum(lambda_q2[layer].astype(f32) * lambda_k2[layer].astype(f32)))
               + lam_init)
        o_b = _diff_attention(dq.reshape(B, S, DIFF_HEADS, 2, DIFF_DH),
                              dk.reshape(B, S, DIFF_HEADS, 2, DIFF_DH),
                              dv.reshape(B, S, DIFF_HEADS, DIFF_DV), lam, slopes)
        o_b = _rms_norm(o_b, diff_norm_w[layer], SUBLN_EPS) * (1.0 - lam_init) * jax.nn.silu(
            dz.astype(f32).reshape(B, S, DIFF_HEADS, DIFF_DV))
        y_b = o_b.reshape(B, S, DIFF_WIDTH).astype(x.dtype) @ w_up_b[layer]

        merged = jax.nn.sigmoid(ma) * y_a + jax.nn.sigmoid(mb) * y_b
        y = merged @ w_out[layer]
        x = _layer_norm(DEEPNORM_ALPHA * x + y, ln_g[layer], ln_b[layer])
    return x
```

```cpp
#include <hip/hip_runtime.h>
#include <stdint.h>
#include <math.h>

typedef unsigned short bf16_t;
__device__ __forceinline__ float bf2f(bf16_t v) { return __uint_as_float(((unsigned)v) << 16); }
__device__ __forceinline__ bf16_t f2bf(float f) { unsigned u = __float_as_uint(f); u += 0x7fffu + ((u >> 16) & 1u); return (bf16_t)(u >> 16); }

constexpr int BATCH = 2, SEQ = 8192, DM = 1024, M = BATCH * SEQ;
constexpr int NIN = 6144, NIN_SRC = 6152;
constexpr float LOG2E = 1.4426950408889634f;
constexpr float C2 = 0.125f * LOG2E;
constexpr float ALPHA = 1.189207115002721f;
constexpr size_t MiB = 1u << 20;
constexpr size_t WS_CTL = 0, WS_GB = 1 * MiB, WS_MISC = 1 * MiB + 512 * 1024;
constexpr size_t WS_WTIN = 2 * MiB, WS_WTA = 14 * MiB, WS_WTB = 15 * MiB, WS_WTO = 16 * MiB;
constexpr size_t WS_XB = 18 * MiB;
constexpr size_t WS_HG = 50 * MiB;
constexpr size_t WS_HQKV = 98 * MiB;
constexpr size_t WS_HZ = 146 * MiB, WS_HDZ = 162 * MiB;
constexpr size_t WS_BM = 178 * MiB;
constexpr size_t WS_QP = 210 * MiB, WS_OI = 226 * MiB;
constexpr size_t WS_END = 242 * MiB;

__device__ __forceinline__ float sigmoidf_(float x) { return 1.f / (1.f + __expf(-x)); }
__device__ __forceinline__ float siluf_(float x) { return x / (1.f + __expf(-x)); }
__device__ __forceinline__ float slope2(int h) { return exp2f(-2.f * (float)(h + 1)) * LOG2E; }
__host__ __device__ __forceinline__ int perm_pos(int k) { const int blk = k & ~31, kk = k & 31; return blk + (kk < 16 ? ((kk >> 2) * 8 + (kk & 3)) : (((kk - 16) >> 2) * 8 + 4 + (kk & 3))); }

__global__ void k_wt(const float* __restrict__ W, int K, int ldw, int N, int mode, bf16_t* __restrict__ out) {
    const size_t idx = (size_t)blockIdx.x * blockDim.x + threadIdx.x;
    if (idx >= (size_t)N * K) return;
    const int n = (int)(idx % N), k = (int)(idx / N);
    const int src = (mode == 1) ? (n < 1536 ? n : n + 8) : n;
    out[(size_t)n * K + k] = f2bf(W[(size_t)k * ldw + src]);
}
__global__ void k_xconv(const float* __restrict__ x, const float* __restrict__ w_in, const float* __restrict__ a_log, const float* __restrict__ dt_bias,
                        bf16_t* __restrict__ xb, float* __restrict__ gb) {
    const int lane = threadIdx.x & 63, row = blockIdx.x * (blockDim.x >> 6) + (threadIdx.x >> 6);
    if (row >= M) return;
    float p[8] = {0, 0, 0, 0, 0, 0, 0, 0};
    for (int j = 0; j < 4; ++j) {
        const int k0 = 4 * (64 * j + lane);
        const float4 v = *(const float4*)(x + (size_t)row * DM + k0);
        const float vv[4] = {v.x, v.y, v.z, v.w};
        ushort4 o; o.x = f2bf(v.x); o.y = f2bf(v.y); o.z = f2bf(v.z); o.w = f2bf(v.w);
        *(ushort4*)(xb + (size_t)row * DM + k0) = o;
        for (int e = 0; e < 4; ++e) {
            const float* wr = w_in + (size_t)(k0 + e) * NIN_SRC + 1536;
            for (int c = 0; c < 8; ++c) p[c] += vv[e] * wr[c];
        }
    }
    for (int c = 0; c < 8; ++c) for (int o = 1; o < 64; o <<= 1) p[c] += __shfl_xor(p[c], o);
    float mine = 0.f;
#pragma unroll
    for (int c = 0; c < 8; ++c) if (lane == c) mine = p[c];
    if (lane < 4) {
        const float z = mine + dt_bias[lane];
        const float sp = z > 20.f ? z : log1pf(expf(z));
        gb[(size_t)row * 8 + lane] = -expf(a_log[lane]) * sp;
    } else if (lane < 8) {
        gb[(size_t)row * 8 + lane] = 1.f / (1.f + expf(-mine));
    }
}
__global__ void k_lam(const float* q1, const float* k1, const float* q2, const float* k2, float* misc) {
    float a = q1[threadIdx.x] * k1[threadIdx.x], b = q2[threadIdx.x] * k2[threadIdx.x];
    for (int o = 1; o < 64; o <<= 1) { a += __shfl_xor(a, o); b += __shfl_xor(b, o); }
    if (threadIdx.x == 0) misc[0] = expf(a) - expf(b) + 0.2f;
}

struct Epi1 {
    bf16_t *hg, *hz, *hqkv, *hdz, *gate;
    __device__ void operator()(int m, int n, float v) const {
        if (n < 1536) hg[(size_t)m * 1536 + n] = f2bf(v);
        else if (n < 2048) hz[(size_t)m * 512 + (n - 1536)] = f2bf(siluf_(v));
        else if (n < 3584) {
            const int c = n - 2048;
            if (c < 512) v *= C2;
            else if (c >= 1024) { if (m & 32) { const int h = (c - 1024) >> 7; v *= exp2f(32.f * slope2(h)); } }
            hqkv[(size_t)m * 1536 + c] = f2bf(v);
        } else if (n < 4096) hdz[(size_t)m * 512 + (n - 3584)] = f2bf(0.8f * siluf_(v));
        else gate[(size_t)m * 2048 + (n - 4096)] = f2bf(sigmoidf_(v));
    }
};
struct Epi2a { const bf16_t* gate; bf16_t* mt;
    __device__ void operator()(int m, int n, float v) const { mt[(size_t)m * 1024 + n] = f2bf(bf2f(gate[(size_t)m * 2048 + n]) * v); } };
struct Epi2b { const bf16_t* gate; const bf16_t* mt; bf16_t* mg;
    __device__ void operator()(int m, int n, float v) const { mg[(size_t)m * 1024 + n] = f2bf(bf2f(mt[(size_t)m * 1024 + n]) + bf2f(gate[(size_t)m * 2048 + 1024 + n]) * v); } };
struct Epi3 { float* y; __device__ void operator()(int m, int n, float v) const { y[(size_t)m * 1024 + n] = v; } };

template <class Epi>
__global__ void __launch_bounds__(256) k_gemm(const bf16_t* __restrict__ A, const bf16_t* __restrict__ Bt, int K, Epi epi) {
    __shared__ float As[32][65], Bs[32][65];
    const int tid = threadIdx.x, tx = tid & 15, ty = tid >> 4;
    const int m0 = blockIdx.y * 64, n0 = blockIdx.x * 64;
    float acc[4][4] = {};
    for (int k0 = 0; k0 < K; k0 += 32) {
        for (int i = tid; i < 64 * 32; i += 256) { const int r = i >> 5, c = i & 31;
            As[c][r] = bf2f(A[(size_t)(m0 + r) * K + k0 + c]); Bs[c][r] = bf2f(Bt[(size_t)(n0 + r) * K + k0 + c]); }
        __syncthreads();
#pragma unroll 8
        for (int k = 0; k < 32; ++k) {
            float a[4], b[4];
#pragma unroll
            for (int i = 0; i < 4; ++i) { a[i] = As[k][ty * 4 + i]; b[i] = Bs[k][tx * 4 + i]; }
#pragma unroll
            for (int i = 0; i < 4; ++i)
#pragma unroll
                for (int j = 0; j < 4; ++j) acc[i][j] += a[i] * b[j];
        }
        __syncthreads();
    }
    for (int i = 0; i < 4; ++i) for (int j = 0; j < 4; ++j) epi(m0 + ty * 4 + i, n0 + tx * 4 + j, acc[i][j]);
}

__global__ void __launch_bounds__(256) k_gdn_prep(const bf16_t* __restrict__ hg, const float* __restrict__ conv_w, const float* __restrict__ gb,
                                                  bf16_t* __restrict__ nmat, bf16_t* __restrict__ bmt, bf16_t* __restrict__ qp, bf16_t* __restrict__ oi, float* __restrict__ gam) {
    extern __shared__ float sm[];
    float* q = sm;
    float* k = q + 64 * 128;
    float* R = k + 64 * 128;
    float* L = R + 64 * 257;
    float* gc = L + 64 * 65;
    float* bt = gc + 64;
    const int ch = blockIdx.x, n = ch & 127, bh = ch >> 7, h = bh & 3, b = bh >> 2;
    const int tid = threadIdx.x;
    const int m0 = b * SEQ + n * 64, t0 = n * 64;
    for (int i = tid; i < 64 * 384; i += 256) {
        const int c = i / 384, e = i % 384, part = e >> 7, d = e & 127;
        const int col = part * 512 + h * 128 + d;
        float s = 0.f;
        for (int j = 0; j < 4; ++j) { const int t = t0 + c - 3 + j; if (t >= 0) s += conv_w[j * 1536 + col] * bf2f(hg[(size_t)(m0 + c - 3 + j) * 1536 + col]); }
        s = siluf_(s);
        if (part == 0) q[c * 128 + d] = s; else if (part == 1) k[c * 128 + d] = s; else R[c * 257 + d] = s;
    }
    if (tid < 64) { bt[tid] = gb[(size_t)(m0 + tid) * 8 + 4 + h]; }
    __syncthreads();
    if (tid == 0) { float a = 0.f; for (int c = 0; c < 64; ++c) { a += gb[(size_t)(m0 + c) * 8 + h]; gc[c] = a; } }
    {
        const int r = tid >> 1, half = tid & 1; float* p = (r < 64 ? q + r * 128 : k + (r - 64) * 128) + half * 64;
        float s = 0.f; for (int d = 0; d < 64; ++d) s += p[d] * p[d];
        s += __shfl_xor(s, 1);
        float sc = rsqrtf(s + 1e-6f); if (r < 64) sc *= 0.08838834764831845f;
        for (int d = 0; d < 64; ++d) p[d] *= sc;
    }
    __syncthreads();
    for (int i = tid; i < 4096; i += 256) {
        const int c = i >> 6, s = i & 63; float kk = 0.f;
        for (int d = 0; d < 128; ++d) kk += k[c * 128 + d] * k[s * 128 + d];
        L[c * 65 + s] = (c > s) ? bt[c] * kk * expf(gc[c] - gc[s]) : 0.f;
    }
    const bool isu = tid < 128; const int d = tid & 127;
    for (int c = 0; c < 64; ++c) R[c * 257 + tid] = isu ? R[c * 257 + d] * bt[c] : k[c * 128 + d] * bt[c] * expf(gc[c]);
    __syncthreads();
    for (int c = 1; c < 64; ++c) { float s = 0.f;
        for (int t = 0; t < c; ++t) s += L[c * 65 + t] * R[t * 257 + tid];
        R[c * 257 + tid] -= s; }
    const float gl = gc[63];
    __syncthreads();
    for (int i = tid; i < 4096; i += 256) {
        const int c = i >> 6, s = i & 63; float qk = 0.f;
        for (int dd = 0; dd < 128; ++dd) qk += q[c * 128 + dd] * k[s * 128 + dd];
        L[c * 65 + s] = (c >= s) ? qk * expf(gc[c] - gc[s]) : 0.f;
    }
    __syncthreads();
    for (int i = tid; i < 64 * 128; i += 256) { const int c = i >> 7, dd = i & 127; k[c * 128 + dd] *= expf(gl - gc[c]); q[c * 128 + dd] *= expf(gc[c]); }
    __syncthreads();
    const float* A = L;
    const size_t base = (size_t)ch * 16384;
    if (isu) {
        for (int dk = 0; dk < 128; ++dk) { float s = 0.f;
            for (int c = 0; c < 64; ++c) s += k[c * 128 + dk] * R[c * 257 + tid];
            bmt[base + (size_t)d * 128 + dk] = f2bf(s); }
        for (int c = 0; c < 64; ++c) { float s = 0.f;
            for (int t = 0; t <= c; ++t) s += A[c * 65 + t] * R[t * 257 + tid];
            oi[(size_t)ch * 8192 + (size_t)c * 128 + d] = f2bf(s); }
    } else {
        const int pos = perm_pos(d);
        for (int dk = 0; dk < 128; ++dk) { float s = 0.f;
            for (int c = 0; c < 64; ++c) s += k[c * 128 + dk] * R[c * 257 + tid];
            nmat[base + (size_t)dk * 128 + pos] = f2bf(-s); }
        for (int c = 0; c < 64; ++c) { float s = 0.f;
            for (int t = 0; t <= c; ++t) s += A[c * 65 + t] * R[t * 257 + tid];
            qp[(size_t)ch * 8192 + (size_t)c * 128 + d] = f2bf(q[c * 128 + d] - s); }
    }
    if (tid == 0) gam[ch] = expf(gl);
}

__global__ void __launch_bounds__(1024) k_gdn_scan(bf16_t* __restrict__ nmat_st, const bf16_t* __restrict__ bmt, const float* __restrict__ gam) {
    extern __shared__ float sm[];
    float* Ns = sm;
    float* Ss = Ns + 128 * 129;
    const int bh = blockIdx.x, tid = threadIdx.x, r = tid & 127, jg = tid >> 7;
    float S[16];
#pragma unroll
    for (int j = 0; j < 16; ++j) S[j] = 0.f;
    for (int n = 0; n < 128; ++n) {
        const int ch = bh * 128 + n; const size_t base = (size_t)ch * 16384;
        for (int i = tid; i < 16384; i += 1024) { const int rr = i >> 7, kk = i & 127; Ns[rr * 129 + kk] = bf2f(nmat_st[base + (size_t)rr * 128 + perm_pos(kk)]); }
#pragma unroll
        for (int j = 0; j < 16; ++j) Ss[r * 128 + jg * 16 + j] = S[j];
        __syncthreads();
#pragma unroll
        for (int j = 0; j < 16; ++j) nmat_st[base + (size_t)(jg * 16 + j) * 128 + r] = f2bf(S[j]);
        const float g = gam[ch];
        float acc[16];
#pragma unroll
        for (int j = 0; j < 16; ++j) acc[j] = bf2f(bmt[base + (size_t)(jg * 16 + j) * 128 + r]);
        for (int kk = 0; kk < 128; ++kk) { const float nv = Ns[r * 129 + kk];
#pragma unroll
            for (int j = 0; j < 16; ++j) acc[j] += nv * Ss[kk * 128 + jg * 16 + j]; }
#pragma unroll
        for (int j = 0; j < 16; ++j) S[j] = g * S[j] + acc[j];
        __syncthreads();
    }
}

__global__ void __launch_bounds__(256) k_attn(const bf16_t* __restrict__ hqkv, bf16_t* __restrict__ ob) {
    __shared__ float Ks[64][65], Vs[64][129], Ps[32][65];
    const int qb = blockIdx.x, bhm = blockIdx.y, mp = bhm & 1, h = (bhm >> 1) & 3, b = bhm >> 3;
    const int tid = threadIdx.x, row = tid >> 3, sub = tid & 7;
    const int i = qb * 32 + row;
    const size_t mrow = (size_t)b * SEQ + i;
    float qv[64];
#pragma unroll
    for (int d = 0; d < 64; ++d) qv[d] = bf2f(hqkv[mrow * 1536 + h * 128 + mp * 64 + d]);
    const float s2 = slope2(h), cinv = exp2f(-32.f * s2);
    float mx = -INFINITY, l = 0.f, o[16];
#pragma unroll
    for (int e = 0; e < 16; ++e) o[e] = 0.f;
    const int ntile = (qb * 32 + 31) / 64 + 1;
    for (int t = 0; t < ntile; ++t) {
        __syncthreads();
        for (int idx = tid; idx < 64 * 64; idx += 256) { const int r = idx >> 6, d = idx & 63; Ks[r][d] = bf2f(hqkv[((size_t)b * SEQ + t * 64 + r) * 1536 + 512 + h * 128 + mp * 64 + d]); }
        for (int idx = tid; idx < 64 * 128; idx += 256) { const int r = idx >> 7, d = idx & 127; Vs[r][d] = bf2f(hqkv[((size_t)b * SEQ + t * 64 + r) * 1536 + 1024 + h * 128 + d]) * ((r & 32) ? cinv : 1.f); }
        __syncthreads();
        float sc[8]; float tm = -INFINITY;
#pragma unroll
        for (int e = 0; e < 8; ++e) { const int jj = sub * 8 + e, j = t * 64 + jj; float s = 0.f;
#pragma unroll
            for (int d = 0; d < 64; ++d) s += qv[d] * Ks[jj][d];
            s += s2 * (float)(j - i); if (j > i) s = -INFINITY; sc[e] = s; tm = fmaxf(tm, s); }
        tm = fmaxf(tm, __shfl_xor(tm, 1)); tm = fmaxf(tm, __shfl_xor(tm, 2)); tm = fmaxf(tm, __shfl_xor(tm, 4));
        const float mn = fmaxf(mx, tm), f = exp2f(mx - mn);
        float ps = 0.f;
#pragma unroll
        for (int e = 0; e < 8; ++e) { const float p = exp2f(sc[e] - mn); Ps[row][sub * 8 + e] = p; ps += p; }
        ps += __shfl_xor(ps, 1); ps += __shfl_xor(ps, 2); ps += __shfl_xor(ps, 4);
        l = l * f + ps; mx = mn;
        __syncthreads();
#pragma unroll
        for (int e = 0; e < 16; ++e) o[e] *= f;
        for (int jj = 0; jj < 64; ++jj) { const float p = Ps[row][jj];
#pragma unroll
            for (int e = 0; e < 16; ++e) o[e] += p * Vs[jj][sub * 16 + e]; }
    }
    const float li = 1.f / l;
#pragma unroll
    for (int e = 0; e < 16; ++e) ob[mrow * 1024 + h * 256 + mp * 128 + sub * 16 + e] = f2bf(o[e] * li);
}

__global__ void __launch_bounds__(256) k_post_a(const bf16_t* __restrict__ qp, const bf16_t* __restrict__ st, const bf16_t* __restrict__ oi, const bf16_t* __restrict__ hz,
                                                 const float* __restrict__ nw, bf16_t* __restrict__ oa) {
    extern __shared__ float sm[];
    float* Q = sm;
    float* St = Q + 64 * 129;
    const int ch = blockIdx.x, n = ch & 127, bh = ch >> 7, h = bh & 3, b = bh >> 2, tid = threadIdx.x;
    for (int i = tid; i < 8192; i += 256) Q[(i >> 7) * 129 + (i & 127)] = bf2f(qp[(size_t)ch * 8192 + i]);
    for (int i = tid; i < 16384; i += 256) St[(i >> 7) * 129 + (i & 127)] = bf2f(st[(size_t)ch * 16384 + i]);
    __syncthreads();
    const int c = tid >> 2, part = tid & 3;
    float ov[32]; float ss = 0.f;
    for (int e = 0; e < 32; ++e) { const int dv = part * 32 + e; float s = bf2f(oi[(size_t)ch * 8192 + c * 128 + dv]);
        for (int dk = 0; dk < 128; ++dk) s += Q[c * 129 + dk] * St[dv * 129 + dk];
        ov[e] = s; ss += s * s; }
    ss += __shfl_xor(ss, 1); ss += __shfl_xor(ss, 2);
    const float rs = rsqrtf(ss * (1.f / 128.f) + 1e-6f);
    const size_t m = (size_t)b * SEQ + n * 64 + c;
    for (int e = 0; e < 32; ++e) { const int dv = part * 32 + e; oa[m * 512 + h * 128 + dv] = f2bf(ov[e] * rs * nw[dv] * bf2f(hz[m * 512 + h * 128 + dv])); }
}
__global__ void __launch_bounds__(256) k_post_b(const bf16_t* __restrict__ ob, const bf16_t* __restrict__ hdz, const float* __restrict__ nw, const float* __restrict__ misc, bf16_t* __restrict__ obn) {
    const int lane = threadIdx.x & 63; const size_t pair = (size_t)blockIdx.x * 4 + (threadIdx.x >> 6);
    const size_t m = pair >> 2; const int h = (int)(pair & 3);
    const float lam = misc[0];
    float v[2]; float ss = 0.f;
    for (int e = 0; e < 2; ++e) { const int d = lane * 2 + e; v[e] = bf2f(ob[m * 1024 + h * 256 + d]) - lam * bf2f(ob[m * 1024 + h * 256 + 128 + d]); ss += v[e] * v[e]; }
    for (int o = 1; o < 64; o <<= 1) ss += __shfl_xor(ss, o);
    const float rs = rsqrtf(ss * (1.f / 128.f) + 1e-5f);
    for (int e = 0; e < 2; ++e) { const int d = lane * 2 + e; obn[m * 512 + h * 128 + d] = f2bf(v[e] * rs * nw[d] * bf2f(hdz[m * 512 + h * 128 + d])); }
}
__global__ void __launch_bounds__(256) k_ln(const float* __restrict__ x, const float* __restrict__ g, const float* __restrict__ bb, float* __restrict__ out) {
    const int lane = threadIdx.x & 63; const size_t row = (size_t)blockIdx.x * 4 + (threadIdx.x >> 6);
    float v[16]; float s = 0.f;
    for (int j = 0; j < 4; ++j) { const int k0 = 4 * (64 * j + lane); const float4 a = *(const float4*)(x + row * DM + k0), y = *(const float4*)(out + row * DM + k0);
        v[4 * j] = ALPHA * a.x + y.x; v[4 * j + 1] = ALPHA * a.y + y.y; v[4 * j + 2] = ALPHA * a.z + y.z; v[4 * j + 3] = ALPHA * a.w + y.w;
        s += v[4 * j] + v[4 * j + 1] + v[4 * j + 2] + v[4 * j + 3]; }
    for (int o = 1; o < 64; o <<= 1) s += __shfl_xor(s, o);
    const float mean = s * (1.f / DM); float q = 0.f;
    for (int e = 0; e < 16; ++e) { v[e] -= mean; q += v[e] * v[e]; }
    for (int o = 1; o < 64; o <<= 1) q += __shfl_xor(q, o);
    const float rstd = rsqrtf(q * (1.f / DM) + 1e-5f);
    for (int j = 0; j < 4; ++j) { const int k0 = 4 * (64 * j + lane); const float4 gg = *(const float4*)(g + k0), b4 = *(const float4*)(bb + k0);
        float4 o; o.x = v[4 * j] * rstd * gg.x + b4.x; o.y = v[4 * j + 1] * rstd * gg.y + b4.y; o.z = v[4 * j + 2] * rstd * gg.z + b4.z; o.w = v[4 * j + 3] * rstd * gg.w + b4.w;
        *(float4*)(out + row * DM + k0) = o; }
}

extern "C" void kernel_launch(void* const* d_in, const int* in_sizes, int n_in, void* d_out, int out_size, void* d_ws, size_t ws_size, hipStream_t stream) {
    const float* x = (const float*)d_in[0]; const float* w_in = (const float*)d_in[1]; const float* conv_w = (const float*)d_in[2];
    const float* a_log = (const float*)d_in[3]; const float* dt_bias = (const float*)d_in[4]; const float* gdn_nw = (const float*)d_in[5];
    const float* w_up_a = (const float*)d_in[6]; const float* lq1 = (const float*)d_in[7]; const float* lk1 = (const float*)d_in[8];
    const float* lq2 = (const float*)d_in[9]; const float* lk2 = (const float*)d_in[10]; const float* diff_nw = (const float*)d_in[11];
    const float* w_up_b = (const float*)d_in[12]; const float* w_out = (const float*)d_in[13]; const float* ln_g = (const float*)d_in[14]; const float* ln_b = (const float*)d_in[15];
    unsigned char* ws = (unsigned char*)d_ws; float* out = (float*)d_out;
    if (ws_size < WS_END) return;
    float* gb = (float*)(ws + WS_GB); float* misc = (float*)(ws + WS_MISC); float* gam = misc + 64;
    bf16_t* wtin = (bf16_t*)(ws + WS_WTIN); bf16_t* wta = (bf16_t*)(ws + WS_WTA); bf16_t* wtb = (bf16_t*)(ws + WS_WTB); bf16_t* wto = (bf16_t*)(ws + WS_WTO);
    bf16_t* xb = (bf16_t*)(ws + WS_XB); bf16_t* nmat = xb; bf16_t* hg = (bf16_t*)(ws + WS_HG); bf16_t* ob = hg;
    bf16_t* hqkv = (bf16_t*)(ws + WS_HQKV); bf16_t* oa = hqkv; bf16_t* obn = (bf16_t*)(ws + WS_HQKV + 16 * MiB);
    bf16_t* hz = (bf16_t*)(ws + WS_HZ); bf16_t* hdz = (bf16_t*)(ws + WS_HDZ);
    bf16_t* bmt = (bf16_t*)(ws + WS_BM); bf16_t* mt = bmt; bf16_t* qp = (bf16_t*)(ws + WS_QP); bf16_t* oi = (bf16_t*)(ws + WS_OI); bf16_t* mg = qp;
    bf16_t* gate = (bf16_t*)d_out;

    k_wt<<<(NIN * 1024 + 255) / 256, 256, 0, stream>>>(w_in, 1024, NIN_SRC, NIN, 1, wtin);
    k_wt<<<(1024 * 512 + 255) / 256, 256, 0, stream>>>(w_up_a, 512, 1024, 1024, 0, wta);
    k_wt<<<(1024 * 512 + 255) / 256, 256, 0, stream>>>(w_up_b, 512, 1024, 1024, 0, wtb);
    k_wt<<<(1024 * 1024 + 255) / 256, 256, 0, stream>>>(w_out, 1024, 1024, 1024, 0, wto);
    k_xconv<<<M / 4, 256, 0, stream>>>(x, w_in, a_log, dt_bias, xb, gb);
    k_lam<<<1, 64, 0, stream>>>(lq1, lk1, lq2, lk2, misc);
    k_gemm<Epi1><<<dim3(NIN / 64, M / 64), 256, 0, stream>>>(xb, wtin, 1024, Epi1{hg, hz, hqkv, hdz, gate});
    {
        const size_t lds = (size_t)(2 * 64 * 128 + 64 * 257 + 64 * 65 + 128) * 4;
        hipFuncSetAttribute((const void*)k_gdn_prep, hipFuncAttributeMaxDynamicSharedMemorySize, (int)lds);
        k_gdn_prep<<<1024, 256, lds, stream>>>(hg, conv_w, gb, nmat, bmt, qp, oi, gam);
    }
    {
        const size_t lds = (size_t)(128 * 129 + 128 * 128) * 4;
        hipFuncSetAttribute((const void*)k_gdn_scan, hipFuncAttributeMaxDynamicSharedMemorySize, (int)lds);
        k_gdn_scan<<<8, 1024, lds, stream>>>(nmat, bmt, gam);
    }
    k_attn<<<dim3(SEQ / 32, 16), 256, 0, stream>>>(hqkv, ob);
    {
        const size_t lds = (size_t)(64 * 129 + 128 * 129) * 4;
        hipFuncSetAttribute((const void*)k_post_a, hipFuncAttributeMaxDynamicSharedMemorySize, (int)lds);
        k_post_a<<<1024, 256, lds, stream>>>(qp, nmat, oi, hz, gdn_nw, oa);
    }
    k_post_b<<<M, 256, 0, stream>>>(ob, hdz, diff_nw, misc, obn);
    k_gemm<Epi2a><<<dim3(1024 / 64, M / 64), 256, 0, stream>>>(oa, wta, 512, Epi2a{gate, mt});
    k_gemm<Epi2b><<<dim3(1024 / 64, M / 64), 256, 0, stream>>>(obn, wtb, 512, Epi2b{gate, mt, mg});
    k_gemm<Epi3><<<dim3(1024 / 64, M / 64), 256, 0, stream>>>(mg, wto, 1024, Epi3{out});
    k_ln<<<M / 4, 256, 0, stream>>>(x, ln_g, ln_b, out);
}
```
